# Optimizing an MI355X kernel written in HIP

```python
import math
import jax, jax.numpy as jnp
from jax import lax
import numpy as np

D_MODEL = 1024
BATCH = 8
SEQ = 4096
DEPTH = 2

N_A_LAYERS = DEPTH // 2
N_B_LAYERS = DEPTH - N_A_LAYERS
CONV_WIDTH = 31
N_HEADS = 16
N_KV_HEADS = 4
HEAD_DIM = 64
Q_PER_KV = N_HEADS // N_KV_HEADS
WINDOW = 128
BLOCK = 128
ROPE_DIM = HEAD_DIM // 4
ROPE_THETA = 500000.0
D_FF = 4 * D_MODEL
PLE_DIM = 256
DEEPNORM_ALPHA = (2 * DEPTH) ** 0.25
DEEPNORM_BETA = (8 * DEPTH) ** -0.25
LN_EPS = 1e-5

kernel_name = "yoco_conformer_swa_sink_deepnorm"


def layer_norm(x, g, b):
    xf = x.astype(jnp.float32)
    mu = jnp.mean(xf, axis=-1, keepdims=True)
    var = jnp.mean(jnp.square(xf - mu), axis=-1, keepdims=True)
    y = (xf - mu) * lax.rsqrt(var + LN_EPS)
    return (y * g.astype(jnp.float32) + b.astype(jnp.float32)).astype(x.dtype)


def rope_tables(seq_len):
    pos = jnp.arange(seq_len, dtype=jnp.float32)
    inv_freq = ROPE_THETA ** (-jnp.arange(0, ROPE_DIM, 2, dtype=jnp.float32) / ROPE_DIM)
    ang = pos[:, None] * inv_freq[None, :]
    return jnp.cos(ang)[:, None, :], jnp.sin(ang)[:, None, :]


def partial_rope(t, cos, sin):
    half = ROPE_DIM // 2
    x1 = t[..., :half].astype(jnp.float32)
    x2 = t[..., half:ROPE_DIM].astype(jnp.float32)
    rot = jnp.concatenate([x1 * cos - x2 * sin, x2 * cos + x1 * sin], axis=-1).astype(t.dtype)
    return jnp.concatenate([rot, t[..., ROPE_DIM:]], axis=-1)


def conformer_conv(x, w_in, b_in, w_dw, b_dw, ln_g, ln_b, w_out, b_out):
    h = x @ w_in + b_in
    a, gate = jnp.split(h, 2, axis=-1)
    h = a * jax.nn.sigmoid(gate)
    h = lax.conv_general_dilated(
        h, w_dw[:, None, :], window_strides=(1,), padding=[(CONV_WIDTH - 1, 0)],
        dimension_numbers=("NWC", "WIO", "NWC"), feature_group_count=D_MODEL) + b_dw
    h = jax.nn.silu(layer_norm(h, ln_g, ln_b))
    return h @ w_out + b_out


def shared_banded_kv(x, w_k, w_v, cos, sin):
    B, T, _ = x.shape
    nb = T // BLOCK
    k = partial_rope((x @ w_k).reshape(B, T, N_KV_HEADS, HEAD_DIM), cos, sin)
    v = (x @ w_v).reshape(B, T, N_KV_HEADS, HEAD_DIM)

    def band(t):
        tb = t.reshape(B, nb, BLOCK, N_KV_HEADS, HEAD_DIM)
        prev = jnp.pad(tb, ((0, 0), (1, 0), (0, 0), (0, 0), (0, 0)))[:, :-1]
        return jnp.concatenate([prev, tb], axis=2)

    return band(k), band(v)


def band_mask(nb):
    n = jnp.arange(nb)[:, None, None]
    a = jnp.arange(BLOCK)[None, :, None]
    s = jnp.arange(2 * BLOCK)[None, None, :]
    qpos = n * BLOCK + a
    kpos = (n - 1) * BLOCK + s
    rel = qpos - kpos
    return (kpos >= 0) & (rel >= 0) & (rel < WINDOW)


def swa_sink_attention(x, w_q, sinks, w_o, kk, vv, cos, sin):
    B, T, _ = x.shape
    nb = T // BLOCK
    q = partial_rope((x @ w_q).reshape(B, T, N_HEADS, HEAD_DIM), cos, sin)
    q = q.reshape(B, nb, BLOCK, N_KV_HEADS, Q_PER_KV, HEAD_DIM)
    scores = jnp.einsum("bnqkgd,bnskd->bnkgqs", q, kk,
                        preferred_element_type=jnp.float32) * (1.0 / math.sqrt(HEAD_DIM))
    mask = band_mask(nb)[None, :, None, None]
    scores = jnp.where(mask, scores, -jnp.inf)
    sink = sinks.astype(jnp.float32).reshape(1, 1, N_KV_HEADS, Q_PER_KV, 1, 1)
    lse = jnp.logaddexp(jax.nn.logsumexp(scores, axis=-1, keepdims=True), sink)
    probs = jnp.exp(scores - lse).astype(vv.dtype)
    out = jnp.einsum("bnkgqs,bnskd->bnqkgd", probs, vv)
    return out.reshape(B, T, N_HEADS * HEAD_DIM) @ w_o


def sq_relu_mlp(x, w_up, w_down):
    return jnp.square(jax.nn.relu(x @ w_up)) @ w_down


def setup_inputs(seed: int = 0) -> dict:
    key = jax.random.key(seed)
    ks = jax.random.split(key, 32)
    f32 = jnp.float32

    def nrm(k, shape, scale):
        return jax.random.normal(k, shape, f32) * scale

    def gain(k, shape):
        return 1.0 + 0.02 * jax.random.normal(k, shape, f32)

    D = D_MODEL
    HD = N_HEADS * HEAD_DIM
    KVD = N_KV_HEADS * HEAD_DIM
    return {
        "x": nrm(ks[0], (BATCH, SEQ, D), 1.0),
        "p": nrm(ks[1], (DEPTH, BATCH, SEQ, PLE_DIM), 1.0),
        "conv_w_in": nrm(ks[2], (N_A_LAYERS, D, 2 * D), D ** -0.5),
        "conv_b_in": nrm(ks[3], (N_A_LAYERS, 2 * D), 0.02),
        "conv_w_dw": nrm(ks[4], (N_A_LAYERS, CONV_WIDTH, D), CONV_WIDTH ** -0.5),
        "conv_b_dw": nrm(ks[5], (N_A_LAYERS, D), 0.02),
        "conv_ln_g": gain(ks[6], (N_A_LAYERS, D)),
        "conv_ln_b": nrm(ks[7], (N_A_LAYERS, D), 0.02),
        "conv_w_out": nrm(ks[8], (N_A_LAYERS, D, D), D ** -0.5 * DEEPNORM_BETA),
        "conv_b_out": nrm(ks[9], (N_A_LAYERS, D), 0.02),
        "kv_w_k": nrm(ks[10], (D, KVD), D ** -0.5),
        "kv_w_v": nrm(ks[11], (D, KVD), D ** -0.5),
        "attn_w_q": nrm(ks[12], (N_B_LAYERS, D, HD), D ** -0.5),
        "attn_sinks": nrm(ks[13], (N_B_LAYERS, N_HEADS), 0.5),
        "attn_w_o": nrm(ks[14], (N_B_LAYERS, HD, D), HD ** -0.5 * DEEPNORM_BETA),
        "mix_ln_g": gain(ks[15], (DEPTH, D)),
        "mix_ln_b": nrm(ks[16], (DEPTH, D), 0.02),
        "mlp_w_up": nrm(ks[17], (DEPTH, D, D_FF), D ** -0.5),
        "mlp_w_down": nrm(ks[18], (DEPTH, D_FF, D), D_FF ** -0.5 * DEEPNORM_BETA),
        "mlp_ln_g": gain(ks[19], (DEPTH, D)),
        "mlp_ln_b": nrm(ks[20], (DEPTH, D), 0.02),
        "ple_w_proj": nrm(ks[21], (DEPTH, PLE_DIM, D), PLE_DIM ** -0.5),
        "ple_w_gate": nrm(ks[22], (DEPTH, D, D), D ** -0.5),
    }


def reference(x, p, conv_w_in, conv_b_in, conv_w_dw, conv_b_dw, conv_ln_g, conv_ln_b,
              conv_w_out, conv_b_out, kv_w_k, kv_w_v, attn_w_q, attn_sinks, attn_w_o,
              mix_ln_g, mix_ln_b, mlp_w_up, mlp_w_down, mlp_ln_g, mlp_ln_b,
              ple_w_proj, ple_w_gate):
    T = x.shape[1]
    cos, sin = rope_tables(T)
    kk = vv = None
    for i in range(DEPTH):
        if i < N_A_LAYERS:
            y = conformer_conv(x, conv_w_in[i], conv_b_in[i], conv_w_dw[i], conv_b_dw[i],
                               conv_ln_g[i], conv_ln_b[i], conv_w_out[i], conv_b_out[i])
        else:
            if i == N_A_LAYERS:
                kk, vv = shared_banded_kv(x, kv_w_k, kv_w_v, cos, sin)
            j = i - N_A_LAYERS
            y = swa_sink_attention(x, attn_w_q[j], attn_sinks[j], attn_w_o[j], kk, vv, cos, sin)
        x = layer_norm(DEEPNORM_ALPHA * x + y, mix_ln_g[i], mix_ln_b[i])
        x = layer_norm(DEEPNORM_ALPHA * x + sq_relu_mlp(x, mlp_w_up[i], mlp_w_down[i]),
                       mlp_ln_g[i], mlp_ln_b[i])
        x = x + (p[i] @ ple_w_proj[i]) * jax.nn.sigmoid(x @ ple_w_gate[i])
    return x
```

```cpp
#include <hip/hip_runtime.h>
#include <hip/hip_cooperative_groups.h>
#include <cstdio>
#include <cstdint>
namespace cg = cooperative_groups;
namespace pg8 {
#define PG8_LAS __attribute__((address_space(3)))
typedef unsigned short bf16_t;
typedef short bf16x8 __attribute__((ext_vector_type(8)));
typedef float f32x4 __attribute__((ext_vector_type(4)));
typedef unsigned u32x4 __attribute__((ext_vector_type(4)));
constexpr int BM = 256, BK = 64, HALF = 128, HTB = HALF * BK * 2  , STAGE_BYTES = 8 * HTB, NXCD = 8, WGM = 8;

__host__ __device__ __forceinline__ int lds_byte(int r, int c) { const int st = (r >> 4) * 2 + (c >> 5), rr = r & 15, cc = c & 31, ob = rr * 64 + cc * 2; return st * 1024 + (ob ^ (((ob >> 9) & 1) << 5)); }
__host__ __device__ __forceinline__ void stage_rc(int b, int& R, int& C) { const int st = b / 1024, sb = b % 1024, swz = sb ^ (((sb >> 9) & 1) << 5); R = (st >> 1) * 16 + swz / 64; C = (st & 1) * 32 + (swz % 64) / 2; }
__host__ __device__ __forceinline__ int perm32(int rho) { const int n = rho >> 4, i = rho & 15; return 8 * (i >> 2) + 4 * n + (i & 3); }

struct Unit { int pm, pn; };
struct Gemm { const bf16_t* A; const bf16_t* Bt; int M, N, K; };

struct StaticOrder {
    int nM, nN, nwg, G, c;
    __host__ __device__ void init(int M, int N, int G_, int c_) { nM = M / BM; nN = N / BM; nwg = nM * nN; G = G_; c = c_; }
    __host__ __device__ bool next(int i, Unit& u) const {
        const long L = (long)i * G + c; if (L >= nwg) return false;
        int wgid = (int)L; { const int q = nwg / NXCD, r = nwg % NXCD, xcd = wgid % NXCD, off = wgid / NXCD; wgid = (xcd < r ? xcd * (q + 1) : r * (q + 1) + (xcd - r) * q) + off; }
        const int nig = WGM * nN, gid = wgid / nig, fm = gid * WGM, gsz = (nM - fm) < WGM ? (nM - fm) : WGM;
        u.pm = fm + ((wgid % nig) % gsz); u.pn = (wgid % nig) / gsz; return true;
    }
    __device__ __forceinline__ void a_ready(const Unit&) const {}
    __device__ __forceinline__ void done(const Unit&) const {}
};

__device__ __forceinline__ unsigned cvt_pk_bf16(float lo, float hi) { unsigned r; asm volatile("v_cvt_pk_bf16_f32 %0, %1, %2" : "=v"(r) : "v"(lo), "v"(hi)); return r; }
typedef float f32x2 __attribute__((ext_vector_type(2)));
template <class Epi, class Sched, bool ALIGN_EPI = false, bool SP2 = false>
__device__ __forceinline__ void gemm_phase(PG8_LAS unsigned char* lds, const Gemm g, const Sched& S, const Epi& E) {
    const int tid = threadIdx.x, wid = __builtin_amdgcn_readfirstlane(tid >> 6), lane = tid & 63, wr = wid >> 2, wc = wid & 3, fr = lane & 15, fq = lane >> 4;
    const int K = g.K, nt = K / BK;
    unsigned voffA[2], voffB[2];
#pragma unroll
    for (int i = 0; i < 2; ++i) { int R, C; stage_rc(tid * 16 + i * 8192, R, C); const int Rb = Epi::PERM ? ((R & ~31) + perm32(R & 31)) : R;
        voffA[i] = (unsigned)(R * K + C) * 2u; voffB[i] = (unsigned)(Rb * K + C) * 2u; }
    const size_t kstep = (size_t)(BK * 2);
    const size_t hstep = (size_t)HALF * K * 2;
    const size_t tstep = 2 * hstep;
    const unsigned ldsw = (unsigned)wid * 1024u;
    const int aoff = lds_byte(wr * 64 + fr, fq * 8), boff = lds_byte(wc * 32 + fr, fq * 8);
#define PG8_SA(b, h) (((b) * 2 + (h)) * HTB)
#define PG8_SB(b, h) ((4 + (b) * 2 + (h)) * HTB)
#define PG8_STAGE(bufoff, gbase, voff) do { _Pragma("unroll") for (int _i = 0; _i < 2; ++_i) \
        __builtin_amdgcn_global_load_lds((const unsigned*)((const char*)(gbase) + (voff)[_i]), (PG8_LAS unsigned*)(lds + (bufoff) + ldsw + _i * 8192), 16, 0, 0); } while (0)
#define PG8_LDA(dst, b, h) do { _Pragma("unroll") for (int m = 0; m < 4; ++m) _Pragma("unroll") for (int k = 0; k < 2; ++k) dst[m][k] = *(const PG8_LAS bf16x8*)(lds + PG8_SA(b, h) + aoff + m * 2048 + k * 1024); } while (0)
#define PG8_LDB(dst, b, h) do { _Pragma("unroll") for (int n = 0; n < 2; ++n) _Pragma("unroll") for (int k = 0; k < 2; ++k) dst[n][k] = *(const PG8_LAS bf16x8*)(lds + PG8_SB(b, h) + boff + n * 2048 + k * 1024); } while (0)
#define PG8_MMA(ai, bj, At, Bt) do { __builtin_amdgcn_s_setprio(1); _Pragma("unroll") for (int m = 0; m < 4; ++m) _Pragma("unroll") for (int n = 0; n < 2; ++n) _Pragma("unroll") for (int k = 0; k < 2; ++k) \
        acc[ai][bj][m][n] = __builtin_amdgcn_mfma_f32_16x16x32_bf16(Bt[n][k], At[m][k], acc[ai][bj][m][n], 0, 0, 0); __builtin_amdgcn_s_setprio(0); } while (0)
#define PG8_WAIT_V(n) asm volatile("s_waitcnt vmcnt(" #n ")" ::: "memory")
#define PG8_WAIT_L(n) asm volatile("s_waitcnt lgkmcnt(" #n ")" ::: "memory")
#define PG8_BAR __builtin_amdgcn_s_barrier()
#define PG8_SCHED __builtin_amdgcn_sched_barrier(0)
    Unit cur, nxt; int ui = 0;
    if (!S.next(0, cur)) return;
    f32x4 acc[2][2][4][2];
#pragma unroll
    for (int a = 0; a < 2; ++a)
#pragma unroll
        for (int b = 0; b < 2; ++b)
#pragma unroll
            for (int m = 0; m < 4; ++m)
#pragma unroll
                for (int n = 0; n < 2; ++n) acc[a][b][m][n] = (f32x4){0.f, 0.f, 0.f, 0.f};
    bf16x8 At[4][2], B0[2][2], B1[2][2];
    const char* cA = (const char*)g.A + (size_t)cur.pm * tstep; const char* cB = (const char*)g.Bt + (size_t)cur.pn * tstep;
    S.a_ready(cur);
    if constexpr (SP2) {
        PG8_STAGE(PG8_SB(0, 0), cB, voffB); PG8_STAGE(PG8_SB(0, 1), cB + hstep, voffB); PG8_STAGE(PG8_SA(0, 0), cA, voffA); PG8_STAGE(PG8_SA(0, 1), cA + hstep, voffA);
        if (wr == 1) PG8_BAR;
        PG8_WAIT_V(2); PG8_BAR;
        PG8_STAGE(PG8_SB(1, 0), cB + kstep, voffB); PG8_STAGE(PG8_SA(1, 0), cA + kstep, voffA); PG8_STAGE(PG8_SB(1, 1), cB + hstep + kstep, voffB);
        PG8_WAIT_V(6); PG8_BAR;
    } else {
        PG8_STAGE(PG8_SB(0, 0), cB, voffB); PG8_STAGE(PG8_SA(0, 0), cA, voffA); PG8_STAGE(PG8_SB(0, 1), cB + hstep, voffB); PG8_STAGE(PG8_SA(0, 1), cA + hstep, voffA);
        if (wr == 1) PG8_BAR;
        PG8_WAIT_V(4); PG8_BAR;
        PG8_STAGE(PG8_SB(1, 0), cB + kstep, voffB); PG8_STAGE(PG8_SA(1, 0), cA + kstep, voffA); PG8_STAGE(PG8_SB(1, 1), cB + hstep + kstep, voffB);
        PG8_WAIT_V(6); PG8_BAR;
    }
    for (;;) {
        const bool has_next = S.next(ui + 1, nxt);
        const char* nA = has_next ? (const char*)g.A + (size_t)nxt.pm * tstep : cA; const char* nB = has_next ? (const char*)g.Bt + (size_t)nxt.pn * tstep : cB;
        for (int t = 0; t < nt; t += 2) {
            const bool last = (t == nt - 2);
            const char* a1 = cA + (size_t)(t + 1) * kstep;
            const char* a2 = last ? nA : cA + (size_t)(t + 2) * kstep; const char* b2 = last ? nB : cB + (size_t)(t + 2) * kstep;
            const char* a3 = a2 + kstep; const char* b3 = b2 + kstep;
            if (last && has_next) S.a_ready(nxt);
            if constexpr (SP2) {
            PG8_LDB(B0, 0, 0); PG8_LDB(B1, 0, 1); PG8_SCHED; PG8_LDA(At, 0, 0); PG8_STAGE(PG8_SA(1, 1), a1 + hstep, voffA);
            PG8_WAIT_V(8); PG8_WAIT_L(0); PG8_BAR; PG8_MMA(0, 0, At, B0); PG8_MMA(0, 1, At, B1); PG8_BAR; PG8_SCHED;
            PG8_LDA(At, 0, 1); PG8_STAGE(PG8_SB(0, 0), b2, voffB); PG8_STAGE(PG8_SB(0, 1), b2 + hstep, voffB); PG8_STAGE(PG8_SA(0, 0), a2, voffA);
            PG8_WAIT_V(8); PG8_WAIT_L(0); PG8_BAR; PG8_MMA(1, 0, At, B0); PG8_MMA(1, 1, At, B1); PG8_BAR; PG8_SCHED;
            PG8_LDB(B0, 1, 0); PG8_LDB(B1, 1, 1); PG8_SCHED; PG8_LDA(At, 1, 0); PG8_STAGE(PG8_SA(0, 1), a2 + hstep, voffA);
            PG8_WAIT_V(8); PG8_WAIT_L(0); PG8_BAR; PG8_MMA(0, 0, At, B0); PG8_MMA(0, 1, At, B1); PG8_BAR; PG8_SCHED;
            PG8_LDA(At, 1, 1); PG8_STAGE(PG8_SB(1, 0), b3, voffB); PG8_STAGE(PG8_SB(1, 1), b3 + hstep, voffB); PG8_STAGE(PG8_SA(1, 0), a3, voffA);
            PG8_WAIT_V(8); PG8_WAIT_L(0); PG8_BAR; PG8_MMA(1, 0, At, B0); PG8_MMA(1, 1, At, B1); PG8_BAR; PG8_SCHED;
            } else {
            PG8_LDB(B0, 0, 0); PG8_SCHED; PG8_LDA(At, 0, 0); PG8_STAGE(PG8_SA(1, 1), a1 + hstep, voffA);
            PG8_WAIT_L(8); PG8_BAR; PG8_WAIT_L(0); PG8_MMA(0, 0, At, B0); PG8_BAR; PG8_SCHED;
            PG8_LDB(B1, 0, 1); PG8_STAGE(PG8_SB(0, 0), b2, voffB);
            PG8_BAR; PG8_WAIT_L(0); PG8_MMA(0, 1, At, B1); PG8_BAR;
            PG8_LDA(At, 0, 1); PG8_STAGE(PG8_SA(0, 0), a2, voffA);
            PG8_BAR; PG8_WAIT_L(0); PG8_MMA(1, 0, At, B0); PG8_BAR; PG8_SCHED;
            PG8_STAGE(PG8_SB(0, 1), b2 + hstep, voffB);
            PG8_WAIT_V(6); PG8_BAR; PG8_MMA(1, 1, At, B1); PG8_BAR;
            PG8_LDB(B0, 1, 0); PG8_SCHED; PG8_LDA(At, 1, 0); PG8_STAGE(PG8_SA(0, 1), a2 + hstep, voffA);
            PG8_WAIT_L(8); PG8_BAR; PG8_WAIT_L(0); PG8_MMA(0, 0, At, B0); PG8_BAR; PG8_SCHED;
            PG8_LDB(B1, 1, 1); PG8_STAGE(PG8_SB(1, 0), b3, voffB);
            PG8_BAR; PG8_WAIT_L(0); PG8_MMA(0, 1, At, B1); PG8_BAR;
            PG8_LDA(At, 1, 1); PG8_STAGE(PG8_SA(1, 0), a3, voffA);
            PG8_BAR; PG8_WAIT_L(0); PG8_MMA(1, 0, At, B0); PG8_BAR; PG8_SCHED;
            PG8_STAGE(PG8_SB(1, 1), b3 + hstep, voffB);
            PG8_WAIT_V(6); PG8_BAR; PG8_MMA(1, 1, At, B1); PG8_BAR;
            }
        }
        if constexpr (ALIGN_EPI) { if (wr == 0) PG8_BAR; }
        if constexpr (!Epi::AFTER_DRAIN) { E(acc, cur, wr, wc, fr, fq); S.done(cur); }
        if (!has_next) break;
#pragma unroll
        for (int a = 0; a < 2; ++a)
#pragma unroll
            for (int b = 0; b < 2; ++b)
#pragma unroll
                for (int m = 0; m < 4; ++m)
#pragma unroll
                    for (int n = 0; n < 2; ++n) acc[a][b][m][n] = (f32x4){0.f, 0.f, 0.f, 0.f};
        cur = nxt; cA = nA; cB = nB; ++ui;
        if constexpr (ALIGN_EPI) { if (wr == 1) PG8_BAR; }
    }
    PG8_WAIT_V(0);
    if constexpr (!ALIGN_EPI) { if (wr == 0) PG8_BAR; }
    PG8_BAR;
    if constexpr (Epi::AFTER_DRAIN) { E.fused(acc, cur, wr, wc, fr, fq, lds, wid, lane); S.done(cur); }
#undef PG8_SA
#undef PG8_SB
#undef PG8_STAGE
#undef PG8_LDA
#undef PG8_LDB
#undef PG8_MMA
#undef PG8_WAIT_V
#undef PG8_WAIT_L
#undef PG8_BAR
#undef PG8_SCHED
}
}

#define LAS __attribute__((address_space(3)))
typedef unsigned short bf16_t;
typedef short bf16x8 __attribute__((ext_vector_type(8)));
typedef short s16x4 __attribute__((ext_vector_type(4)));
typedef float f32x4 __attribute__((ext_vector_type(4)));
typedef float f32x2 __attribute__((ext_vector_type(2)));
typedef float f32x16 __attribute__((ext_vector_type(16)));
typedef unsigned u32x4 __attribute__((ext_vector_type(4)));
typedef unsigned u32x2 __attribute__((ext_vector_type(2)));
typedef __bf16 bf16x2_t __attribute__((ext_vector_type(2)));

#ifndef MK_PER_PHASE
#define MK_PER_PHASE 1
#endif

constexpr int NWAVES = 8;
constexpr int BATCH = 8, SEQ = 4096, D = 1024, FF = 4096, PLE = 256, M = BATCH * SEQ;
constexpr int NKVQ = 1536;
constexpr float ALPHA = 1.41421356237309515f;
constexpr float LN_EPS = 1e-5f;

constexpr size_t MiB = 1u << 20;
constexpr size_t WS_CTL = 0, CTL_ZERO_BYTES = 1 * MiB;
constexpr size_t WS_ROPE = 1 * MiB;
constexpr size_t WS_WIN = 2 * MiB, WS_WOUT = 6 * MiB, WS_WUP = 8 * MiB, WS_WDN = 24 * MiB, WS_WPROJ = 40 * MiB, WS_WGATE = 41 * MiB, WS_WKVQ = 45 * MiB, WS_WO = 48 * MiB;
constexpr size_t WS_XB = 64 * MiB;
constexpr size_t WS_PB = 128 * MiB;
constexpr size_t WS_PP = 160 * MiB;
constexpr size_t WS_R1 = 224 * MiB;
constexpr size_t WS_END = 480 * MiB;

constexpr int LDS_BYTES = 147456;

__device__ __forceinline__ unsigned pk2(float lo, float hi) { f32x2 v = {lo, hi}; bf16x2_t b = __builtin_convertvector(v, bf16x2_t); return __builtin_bit_cast(unsigned, b); }
__device__ __forceinline__ float sigm(float x) { return __builtin_amdgcn_rcpf(1.f + __expf(-x)); }
__device__ __forceinline__ float bflo(unsigned u) { return __uint_as_float(u << 16); }
__device__ __forceinline__ float bfhi(unsigned u) { return __uint_as_float(u & 0xffff0000u); }
__device__ __forceinline__ float wave_sum(float v) {
#pragma unroll
    for (int o = 1; o < 64; o <<= 1) v += __shfl_xor(v, o);
    return v;
}
#define MEMFENCE() asm volatile("" ::: "memory")

using pg8::Unit;
typedef const pg8::f32x4 (&AccRef)[2][2][4][2];

struct EpiGLU {
    static constexpr bool PERM = true, AFTER_DRAIN = false;
    bf16_t* G; const float* bias;
    __device__ __forceinline__ void operator()(AccRef acc, const Unit& u, int wr, int wc, int fr, int fq) const {
        const int row0 = u.pm * 256 + wr * 64 + fr, c0 = u.pn * 128 + wc * 32 + 8 * fq;
        f32x4 ba[2], bg[2];
#pragma unroll
        for (int n = 0; n < 2; ++n) { ba[n] = *(const f32x4*)(bias + c0 + 4 * n); bg[n] = *(const f32x4*)(bias + 1024 + c0 + 4 * n); }
#pragma unroll
        for (int ai = 0; ai < 2; ++ai)
#pragma unroll
            for (int m = 0; m < 4; ++m) {
                const size_t row = (size_t)(row0 + ai * 128 + m * 16);
                unsigned w[4];
#pragma unroll
                for (int n = 0; n < 2; ++n) { const f32x4 a = acc[ai][0][m][n] + ba[n], g = acc[ai][1][m][n] + bg[n];
                    w[2 * n] = pk2(a[0] * sigm(g[0]), a[1] * sigm(g[1])); w[2 * n + 1] = pk2(a[2] * sigm(g[2]), a[3] * sigm(g[3])); }
                *(u32x4*)(G + row * D + c0) = (u32x4){w[0], w[1], w[2], w[3]};
            }
    }
};
template <int ACT  > struct EpiBf {
    static constexpr bool PERM = true, AFTER_DRAIN = false;
    bf16_t* O; int ldc;
    __device__ __forceinline__ void operator()(AccRef acc, const Unit& u, int wr, int wc, int fr, int fq) const {
        const int row0 = u.pm * 256 + wr * 64 + fr, c0 = u.pn * 256 + wc * 32 + 8 * fq;
#pragma unroll
        for (int ai = 0; ai < 2; ++ai)
#pragma unroll
            for (int m = 0; m < 4; ++m) {
                bf16_t* rowp = O + (size_t)(row0 + ai * 128 + m * 16) * ldc + c0;
#pragma unroll
                for (int bj = 0; bj < 2; ++bj) { f32x4 v0 = acc[ai][bj][m][0], v1 = acc[ai][bj][m][1];
                    if (ACT == 1) {
#pragma unroll
                        for (int j = 0; j < 4; ++j) { const float a = fmaxf(v0[j], 0.f), b = fmaxf(v1[j], 0.f); v0[j] = a * a; v1[j] = b * b; } }
                    *(u32x4*)(rowp + bj * 128) = (u32x4){pk2(v0[0], v0[1]), pk2(v0[2], v0[3]), pk2(v1[0], v1[1]), pk2(v1[2], v1[3])}; }
            }
    }
};
struct EpiRes {
    static constexpr bool PERM = true, AFTER_DRAIN = false;
    const float* base; float* out; const float* bias;
    __device__ __forceinline__ void operator()(AccRef acc, const Unit& u, int wr, int wc, int fr, int fq) const {
        const int row0 = u.pm * 256 + wr * 64 + fr, c0 = u.pn * 256 + wc * 32 + 8 * fq;
        f32x4 bv[2][2];
#pragma unroll
        for (int bj = 0; bj < 2; ++bj)
#pragma unroll
            for (int n = 0; n < 2; ++n) bv[bj][n] = bias ? *(const f32x4*)(bias + c0 + bj * 128 + 4 * n) : (f32x4){0.f, 0.f, 0.f, 0.f};
#pragma unroll
        for (int ai = 0; ai < 2; ++ai)
#pragma unroll
            for (int m = 0; m < 4; ++m) {
                const size_t off = (size_t)(row0 + ai * 128 + m * 16) * D + c0;
#pragma unroll
                for (int bj = 0; bj < 2; ++bj)
#pragma unroll
                    for (int n = 0; n < 2; ++n) { const f32x4 bs = *(const f32x4*)(base + off + bj * 128 + 4 * n);
                        *(f32x4*)(out + off + bj * 128 + 4 * n) = bs * ALPHA + acc[ai][bj][m][n] + bv[bj][n]; }
                MEMFENCE();
            }
    }
};
struct EpiGate {
    static constexpr bool PERM = true, AFTER_DRAIN = false;
    float* X; bf16_t* PP; bf16_t* Xb; int mode;
    __device__ __forceinline__ void operator()(AccRef acc, const Unit& u, int wr, int wc, int fr, int fq) const {
        const int row0 = u.pm * 256 + wr * 64 + fr, c0 = u.pn * 256 + wc * 32 + 8 * fq;
        if (mode == 0) {
#pragma unroll
            for (int ai = 0; ai < 2; ++ai)
#pragma unroll
                for (int m = 0; m < 4; ++m) {
                    bf16_t* rowp = PP + (size_t)(row0 + ai * 128 + m * 16) * D + c0;
#pragma unroll
                    for (int bj = 0; bj < 2; ++bj) { const f32x4 v0 = acc[ai][bj][m][0], v1 = acc[ai][bj][m][1];
                        *(u32x4*)(rowp + bj * 128) = (u32x4){pk2(v0[0], v0[1]), pk2(v0[2], v0[3]), pk2(v1[0], v1[1]), pk2(v1[2], v1[3])}; }
                }
            return;
        }
#pragma unroll
        for (int ai = 0; ai < 2; ++ai)
#pragma unroll
            for (int m = 0; m < 4; ++m) {
                const size_t off = (size_t)(row0 + ai * 128 + m * 16) * D + c0;
#pragma unroll
                for (int bj = 0; bj < 2; ++bj) {
                    const f32x4 x0 = *(const f32x4*)(X + off + bj * 128), x1 = *(const f32x4*)(X + off + bj * 128 + 4);
                    const u32x4 pp = *(const u32x4*)(PP + off + bj * 128);
                    const f32x4 a0 = acc[ai][bj][m][0], a1 = acc[ai][bj][m][1];
                    f32x4 y0, y1;
                    y0[0] = x0[0] + bflo(pp[0]) * sigm(a0[0]); y0[1] = x0[1] + bfhi(pp[0]) * sigm(a0[1]); y0[2] = x0[2] + bflo(pp[1]) * sigm(a0[2]); y0[3] = x0[3] + bfhi(pp[1]) * sigm(a0[3]);
                    y1[0] = x1[0] + bflo(pp[2]) * sigm(a1[0]); y1[1] = x1[1] + bfhi(pp[2]) * sigm(a1[1]); y1[2] = x1[2] + bflo(pp[3]) * sigm(a1[2]); y1[3] = x1[3] + bfhi(pp[3]) * sigm(a1[3]);
                    *(f32x4*)(X + off + bj * 128) = y0; *(f32x4*)(X + off + bj * 128 + 4) = y1;
                    if (Xb) *(u32x4*)(Xb + off + bj * 128) = (u32x4){pk2(y0[0], y0[1]), pk2(y0[2], y0[3]), pk2(y1[0], y1[1]), pk2(y1[2], y1[3])};
                    MEMFENCE();
                }
            }
    }
};
struct EpiKVQ {
    static constexpr bool PERM = true, AFTER_DRAIN = false;
    bf16_t* O; const float* rope;
    __device__ __forceinline__ void operator()(AccRef acc, const Unit& u, int wr, int wc, int fr, int fq) const {
        const int row0 = u.pm * 256 + wr * 64 + fr, c0 = u.pn * 256 + wc * 32 + 8 * fq;
        const bool do_rope = (u.pn != 1) && ((wc & 1) == 0);
        const float sc = (u.pn >= 2) ? 0.125f : 1.f;
        const float sgn = (fq == 0) ? -1.f : 1.f;
#pragma unroll
        for (int ai = 0; ai < 2; ++ai)
#pragma unroll
            for (int m = 0; m < 4; ++m) {
                const int row = row0 + ai * 128 + m * 16;
                bf16_t* rowp = O + (size_t)row * NKVQ + c0;
                f32x4 cs[4];
                if (do_rope) { const f32x4* rp = (const f32x4*)(rope + (size_t)(row & (SEQ - 1)) * 16);
#pragma unroll
                    for (int k = 0; k < 4; ++k) cs[k] = rp[k]; }
#pragma unroll
                for (int bj = 0; bj < 2; ++bj) { f32x4 v0 = acc[ai][bj][m][0], v1 = acc[ai][bj][m][1];
                    if (do_rope) {
                        f32x4 p0, p1;
#pragma unroll
                        for (int j = 0; j < 4; ++j) { p0[j] = __shfl_xor(v0[j], 16); p1[j] = __shfl_xor(v1[j], 16); }
                        if (fq < 2) {
                            v0[0] = v0[0] * cs[0][0] + sgn * p0[0] * cs[0][1]; v0[1] = v0[1] * cs[0][2] + sgn * p0[1] * cs[0][3];
                            v0[2] = v0[2] * cs[1][0] + sgn * p0[2] * cs[1][1]; v0[3] = v0[3] * cs[1][2] + sgn * p0[3] * cs[1][3];
                            v1[0] = v1[0] * cs[2][0] + sgn * p1[0] * cs[2][1]; v1[1] = v1[1] * cs[2][2] + sgn * p1[1] * cs[2][3];
                            v1[2] = v1[2] * cs[3][0] + sgn * p1[2] * cs[3][1]; v1[3] = v1[3] * cs[3][2] + sgn * p1[3] * cs[3][3];
                        }
                    }
                    v0 = v0 * sc; v1 = v1 * sc;
                    *(u32x4*)(rowp + bj * 128) = (u32x4){pk2(v0[0], v0[1]), pk2(v0[2], v0[3]), pk2(v1[0], v1[1]), pk2(v1[2], v1[3])}; }
            }
    }
};

__device__ __forceinline__ void transpose_item(const float* W, int K, int N, bf16_t* WT, int row_off, int glu, LAS float* scr, int item, int lane) {
    const int nblk = N / 32, kb = item / nblk, nb = item % nblk, k0 = 64 * kb, n0 = 32 * nb;
#pragma unroll 8
    for (int i = 0; i < 32; ++i) { const int kk = 2 * i + (lane >> 5); scr[kk * 33 + (lane & 31)] = W[(size_t)(k0 + kk) * N + n0 + (lane & 31)]; }
    asm volatile("s_waitcnt lgkmcnt(0)" ::: "memory");
    int d0 = row_off + n0;
    if (glu) { const int hf = n0 >> 10, nn = n0 & 1023; d0 = 256 * (nn >> 7) + 128 * hf + (nn & 127); }
    const int c = lane & 7;
#pragma unroll
    for (int j = 0; j < 4; ++j) { const int n = (lane >> 3) + 8 * j; const LAS float* s = scr + (8 * c) * 33 + n;
        u32x4 o; o.x = pk2(s[0 * 33], s[1 * 33]); o.y = pk2(s[2 * 33], s[3 * 33]); o.z = pk2(s[4 * 33], s[5 * 33]); o.w = pk2(s[6 * 33], s[7 * 33]);
        *(u32x4*)(WT + (size_t)(d0 + n) * K + k0 + 8 * c) = o; }
    asm volatile("s_waitcnt lgkmcnt(0)" ::: "memory");
}

struct Args { const float* in[23]; float* out; unsigned char* ws; int ph_lo, ph_hi; };
__device__ __forceinline__ const float* argp(int k) { asm volatile("" : "+s"(k)); return (const float*)((const unsigned long long __attribute__((address_space(4)))*)__builtin_amdgcn_kernarg_segment_ptr())[k]; }

__device__ __forceinline__ void conv_phase(LAS unsigned char* lds, const bf16_t* Gb, bf16_t* U, const float* wdw, const float* bdw, const float* lng, const float* lnb, int G, int bid) {
    const int tid = threadIdx.x, lane = tid & 63, wid = tid >> 6;
    float w0[31], w1[31];
#pragma unroll
    for (int k = 0; k < 31; ++k) { const f32x2 w = *(const f32x2*)(wdw + k * D + 2 * tid); w0[k] = w.x; w1[k] = w.y; }
    const f32x2 bd = *(const f32x2*)(bdw + 2 * tid), lg = *(const f32x2*)(lng + 2 * tid), lb = *(const f32x2*)(lnb + 2 * tid);
    LAS unsigned* tile = (LAS unsigned*)lds;
    LAS float* red = (LAS float*)(lds + 62 * 2048);
    LAS float* stat = red + 512;
    for (int unit = bid; unit < M / 32; unit += G) {
        const int t0 = unit * 32, tin = t0 & (SEQ - 1);
        __syncthreads();
        for (int idx = tid; idx < 62 * 128; idx += 512) { const int j = idx >> 7, c = idx & 127; u32x4 v = {0u, 0u, 0u, 0u};
            if (tin - 30 + j >= 0) v = *(const u32x4*)(Gb + (size_t)(t0 - 30 + j) * D + c * 8);
            *(LAS u32x4*)(lds + j * 2048 + c * 16) = v; }
        __syncthreads();
#pragma unroll 1
        for (int half = 0; half < 2; ++half) {
            const int tb = 16 * half;
            float a0[16], a1[16];
#pragma unroll
            for (int tt0 = 0; tt0 < 16; tt0 += 8) {
#pragma unroll
                for (int o = 0; o < 8; ++o) { a0[tt0 + o] = bd.x; a1[tt0 + o] = bd.y; }
#pragma unroll
                for (int k = 0; k < 38; ++k) {
                    const unsigned pv = tile[(tb + tt0 + k) * 512 + tid];
                    const float v0 = bflo(pv), v1 = bfhi(pv);
#pragma unroll
                    for (int o = 0; o < 8; ++o) { const int tap = k - o; if (tap >= 0 && tap <= 30) { a0[tt0 + o] += v0 * w0[tap]; a1[tt0 + o] += v1 * w1[tap]; } }
                }
                MEMFENCE();
            }
            float ss = 0.f, sq = 0.f;
#pragma unroll
            for (int tt = 0; tt < 16; ++tt) { float s = a0[tt] + a1[tt], q = a0[tt] * a0[tt] + a1[tt] * a1[tt];
#pragma unroll
                for (int o = 1; o < 64; o <<= 1) { s += __shfl_xor(s, o); q += __shfl_xor(q, o); }
                if (lane == tt) { ss = s; sq = q; } }
            if (lane < 16) { red[wid * 32 + lane] = ss; red[wid * 32 + 16 + lane] = sq; }
            __syncthreads();
            if (tid < 16) { float s = 0.f, q = 0.f;
#pragma unroll
                for (int w = 0; w < 8; ++w) { s += red[w * 32 + tid]; q += red[w * 32 + 16 + tid]; }
                const float mean = s * (1.f / D), var = fmaxf(q * (1.f / D) - mean * mean, 0.f); stat[2 * tid] = mean; stat[2 * tid + 1] = 1.0f / sqrtf(var + LN_EPS); }
            __syncthreads();
#pragma unroll
            for (int tt = 0; tt < 16; ++tt) { const float mean = stat[2 * tt], rstd = stat[2 * tt + 1];
                float y0 = (a0[tt] - mean) * rstd * lg.x + lb.x, y1 = (a1[tt] - mean) * rstd * lg.y + lb.y;
                y0 = y0 * sigm(y0); y1 = y1 * sigm(y1);
                *(unsigned*)(U + (size_t)(t0 + tb + tt) * D + 2 * tid) = pk2(y0, y1); }
        }
    }
}

__device__ __forceinline__ void ln_phase(float* X, bf16_t* Xb, const float* g, const float* b, int gw, int NGW, int lane) {
    f32x4 gv[4], bv[4];
#pragma unroll
    for (int j = 0; j < 4; ++j) { gv[j] = ((const f32x4*)g)[lane + 64 * j]; bv[j] = ((const f32x4*)b)[lane + 64 * j]; }
    for (int m = gw; m < M; m += NGW) {
        f32x4* xr = (f32x4*)(X + (size_t)m * D) + lane; f32x4 v[4]; float s = 0.f;
#pragma unroll
        for (int j = 0; j < 4; ++j) { v[j] = xr[64 * j]; s += (v[j].x + v[j].y) + (v[j].z + v[j].w); }
        const float mean = wave_sum(s) * (1.f / D); float s2 = 0.f;
#pragma unroll
        for (int j = 0; j < 4; ++j) { v[j] = v[j] - mean; s2 += (v[j].x * v[j].x + v[j].y * v[j].y) + (v[j].z * v[j].z + v[j].w * v[j].w); }
        const float rstd = 1.f / sqrtf(wave_sum(s2) * (1.f / D) + LN_EPS);
        u32x2* o8 = (u32x2*)(Xb + (size_t)m * D) + lane;
#pragma unroll
        for (int j = 0; j < 4; ++j) { const f32x4 y = v[j] * rstd * gv[j] + bv[j]; xr[64 * j] = y; o8[64 * j] = (u32x2){pk2(y.x, y.y), pk2(y.z, y.w)}; }
    }
}

__device__ __forceinline__ int crow(int i, int h) { return (i & 3) + 8 * (i >> 2) + 4 * h; }
__device__ __forceinline__ void attn_phase(LAS unsigned char* lds, const bf16_t* KVQ, bf16_t* AO, const float* sinks, int G, int bid) {
    const int tid = threadIdx.x, lane = tid & 63, wid = __builtin_amdgcn_readfirstlane(tid >> 6), r = lane & 31, h = lane >> 5;
    const int g = wid >> 1, hq = wid & 1;
    constexpr int KP = 144, VP = 528;
    LAS unsigned char* Ks = lds; LAS unsigned char* Vs = lds + 256 * KP;
    for (int unit = bid; unit < BATCH * 32 * 4; unit += G) {
        const int kvh = unit & 3, n = (unit >> 2) & 31, b = unit >> 7;
        const long tok0 = (long)b * SEQ + n * 128, ktok0 = tok0 - 128;
        __syncthreads();
#pragma unroll
        for (int i = 0; i < 4; ++i) { const int idx = tid + 512 * i, key = idx >> 3, c = idx & 7; long tk = ktok0 + key; tk = tk < 0 ? 0 : tk;
            const u32x4 v = *(const u32x4*)(KVQ + (size_t)tk * NKVQ + kvh * 64 + c * 8);
            *(LAS u32x4*)(Ks + key * KP + c * 16) = v; }
#pragma unroll
        for (int i = 0; i < 4; ++i) { const int key = tid & 255, c = (tid >> 8) + 2 * i; long tk = ktok0 + key; tk = tk < 0 ? 0 : tk;
            const u32x4 v = *(const u32x4*)(KVQ + (size_t)tk * NKVQ + 256 + kvh * 64 + c * 8);
#pragma unroll
            for (int j = 0; j < 8; ++j) { const unsigned short e = (unsigned short)((v[j >> 1] >> (16 * (j & 1))) & 0xffffu); *(LAS unsigned short*)(Vs + (8 * c + j) * VP + key * 2) = e; } }
        __syncthreads();
        const int head = kvh * 4 + g;
        const float sink = sinks[head];
#pragma unroll 1
        for (int qt = 0; qt < 2; ++qt) {
            const int a0 = 64 * hq + 32 * qt;
            const bf16_t* qp = KVQ + (size_t)(tok0 + a0 + r) * NKVQ + 512 + head * 64 + 8 * h;
            bf16x8 qf[4];
#pragma unroll
            for (int ks = 0; ks < 4; ++ks) qf[ks] = *(const bf16x8*)(qp + 16 * ks);
            f32x16 s[5];
#pragma unroll
            for (int kt = 0; kt < 5; ++kt) {
#pragma unroll
                for (int i = 0; i < 16; ++i) s[kt][i] = 0.f;
#pragma unroll
                for (int ks = 0; ks < 4; ++ks) { const bf16x8 kf = *(const LAS bf16x8*)(Ks + (a0 + 32 * kt + r) * KP + (16 * ks + 8 * h) * 2);
                    s[kt] = __builtin_amdgcn_mfma_f32_32x32x16_bf16(kf, qf[ks], s[kt], 0, 0, 0); }
            }
            float mx = -INFINITY;
#pragma unroll
            for (int kt = 0; kt < 5; ++kt)
#pragma unroll
                for (int i = 0; i < 16; ++i) { const int rel = 32 * kt + crow(i, h) - r; const bool valid = (rel >= 1) && (rel <= 128) && (n > 0 || (a0 + r + rel) >= 128);
                    const float v = valid ? s[kt][i] : -INFINITY; s[kt][i] = v; mx = fmaxf(mx, v); }
            mx = fmaxf(mx, __shfl_xor(mx, 32));
            float l = 0.f;
#pragma unroll
            for (int kt = 0; kt < 5; ++kt)
#pragma unroll
                for (int i = 0; i < 16; ++i) { const float p = __expf(s[kt][i] - mx); s[kt][i] = p; l += p; }
            l += __shfl_xor(l, 32);
            l += __expf(sink - mx);
            f32x16 o[2];
#pragma unroll
            for (int i = 0; i < 16; ++i) { o[0][i] = 0.f; o[1][i] = 0.f; }
#pragma unroll
            for (int kt = 0; kt < 5; ++kt)
#pragma unroll
                for (int st = 0; st < 2; ++st) {
                    u32x4 pw; pw[0] = pk2(s[kt][8 * st + 0], s[kt][8 * st + 1]); pw[1] = pk2(s[kt][8 * st + 2], s[kt][8 * st + 3]); pw[2] = pk2(s[kt][8 * st + 4], s[kt][8 * st + 5]); pw[3] = pk2(s[kt][8 * st + 6], s[kt][8 * st + 7]);
                    const bf16x8 pf = __builtin_bit_cast(bf16x8, pw);
                    const int kb = a0 + 32 * kt + 16 * st + 4 * h;
#pragma unroll
                    for (int dt = 0; dt < 2; ++dt) { const LAS unsigned char* vp = Vs + (32 * dt + r) * VP + kb * 2;
                        const s16x4 lo = *(const LAS s16x4*)(vp), hi = *(const LAS s16x4*)(vp + 16);
                        const bf16x8 vf = __builtin_shufflevector(lo, hi, 0, 1, 2, 3, 4, 5, 6, 7);
                        o[dt] = __builtin_amdgcn_mfma_f32_32x32x16_bf16(vf, pf, o[dt], 0, 0, 0); }
                }
            const float inv = 1.0f / l;
            bf16_t* op = AO + (size_t)(tok0 + a0 + r) * D + head * 64 + 4 * h;
#pragma unroll
            for (int dt = 0; dt < 2; ++dt)
#pragma unroll
                for (int i4 = 0; i4 < 4; ++i4) *(u32x2*)(op + 32 * dt + 8 * i4) = (u32x2){pk2(o[dt][4 * i4] * inv, o[dt][4 * i4 + 1] * inv), pk2(o[dt][4 * i4 + 2] * inv, o[dt][4 * i4 + 3] * inv)};
        }
    }
}

constexpr int NPH = 17;
__global__ void __launch_bounds__(NWAVES * 64, 2) yoco_fwd(Args args) {
    extern __shared__ __attribute__((aligned(16))) unsigned char lds_raw[];
    LAS unsigned char* lds = (LAS unsigned char*)lds_raw;
    const int tid = threadIdx.x, lane = tid & 63, wave = __builtin_amdgcn_readfirstlane(tid >> 6);
    const int G = gridDim.x, bid = blockIdx.x;
    const int gw = bid * NWAVES + wave, NGW = G * NWAVES;
    unsigned char* ws = (unsigned char*)argp(24);
    float* out = (float*)argp(23);
    float* rope = (float*)(ws + WS_ROPE);
    bf16_t* WinT = (bf16_t*)(ws + WS_WIN); bf16_t* WoutT = (bf16_t*)(ws + WS_WOUT); bf16_t* WupT = (bf16_t*)(ws + WS_WUP); bf16_t* WdnT = (bf16_t*)(ws + WS_WDN);
    bf16_t* WprojT = (bf16_t*)(ws + WS_WPROJ); bf16_t* WgateT = (bf16_t*)(ws + WS_WGATE); bf16_t* WkvqT = (bf16_t*)(ws + WS_WKVQ); bf16_t* WoT = (bf16_t*)(ws + WS_WO);
    bf16_t* Xb = (bf16_t*)(ws + WS_XB); bf16_t* Pb = (bf16_t*)(ws + WS_PB); bf16_t* PP = (bf16_t*)(ws + WS_PP);
    bf16_t* Hb = (bf16_t*)(ws + WS_R1); bf16_t* Gb = (bf16_t*)(ws + WS_R1); bf16_t* Ub = (bf16_t*)(ws + WS_R1 + 64 * MiB);
    bf16_t* KVQ = (bf16_t*)(ws + WS_R1); bf16_t* AO = (bf16_t*)(ws + WS_R1 + 128 * MiB); bf16_t* Xb2 = (bf16_t*)(ws + WS_R1 + 192 * MiB);
    cg::grid_group grid = cg::this_grid();
    const int lo = args.ph_lo, hi = args.ph_hi;
#define IN(k) (lo <= (k) && (k) < hi)
#define SEAM(k) do { if (IN(k) && IN((k) + 1)) grid.sync(); } while (0)

    if (IN(0)) {
        LAS float* scr = (LAS float*)(lds + wave * 16384);
        for (int it = gw; it < 12288; it += NGW) {
            int r = it;
#define TR(Wp, Kk, Nn, WTp, roff, glu) { constexpr int cnt_ = ((Kk) / 64) * ((Nn) / 32); if (r < cnt_) { transpose_item((Wp), (Kk), (Nn), (WTp), (roff), (glu), scr, r, lane); continue; } r -= cnt_; }
            TR(argp(17), D, FF, WupT, 0, 0)
            TR(argp(17) + (size_t)D * FF, D, FF, WupT + (size_t)D * FF, 0, 0)
            TR(argp(18), FF, D, WdnT, 0, 0)
            TR(argp(18) + (size_t)D * FF, FF, D, WdnT + (size_t)D * FF, 0, 0)
            TR(argp(2), D, 2 * D, WinT, 0, 1)
            TR(argp(8), D, D, WoutT, 0, 0)
            TR(argp(21), PLE, D, WprojT, 0, 0)
            TR(argp(21) + (size_t)PLE * D, PLE, D, WprojT + (size_t)PLE * D, 0, 0)
            TR(argp(22), D, D, WgateT, 0, 0)
            TR(argp(22) + (size_t)D * D, D, D, WgateT + (size_t)D * D, 0, 0)
            TR(argp(10), D, 256, WkvqT, 0, 0)
            TR(argp(11), D, 256, WkvqT, 256, 0)
            TR(argp(12), D, D, WkvqT, 512, 0)
            TR(argp(14), D, D, WoT, 0, 0)
#undef TR
        }
        const int gt = bid * (NWAVES * 64) + tid, NT = G * NWAVES * 64;
        const f32x4* xin4 = (const f32x4*)argp(0); const f32x4* pin4 = (const f32x4*)argp(1);
        for (int i = gt; i < M * D / 8; i += NT) { const f32x4 a = xin4[2 * i], b = xin4[2 * i + 1];
            ((u32x4*)Xb)[i] = (u32x4){pk2(a.x, a.y), pk2(a.z, a.w), pk2(b.x, b.y), pk2(b.z, b.w)}; }
        for (int i = gt; i < 2 * M * PLE / 8; i += NT) { const f32x4 a = pin4[2 * i], b = pin4[2 * i + 1];
            ((u32x4*)Pb)[i] = (u32x4){pk2(a.x, a.y), pk2(a.z, a.w), pk2(b.x, b.y), pk2(b.z, b.w)}; }
        for (int i = gt; i < SEQ * 8; i += NT) { const int pos = i >> 3, fi = i & 7; const float inv_freq = powf(500000.0f, -(float)(2 * fi) / 16.0f); const float ang = (float)pos * inv_freq;
            rope[2 * i] = cosf(ang); rope[2 * i + 1] = sinf(ang); }
    }
    SEAM(0);
    if (IN(1)) { pg8::Gemm g{Xb, WinT, M, 2 * D, D}; pg8::StaticOrder S; S.init(M, 2 * D, G, bid);
        EpiGLU E{Gb, argp(3)}; pg8::gemm_phase<EpiGLU, pg8::StaticOrder, true, true>(lds, g, S, E); }
    SEAM(1);
    if (IN(2)) conv_phase(lds, Gb, Ub, argp(4), argp(5), argp(6), argp(7), G, bid);
    SEAM(2);
    if (IN(3)) { pg8::Gemm g{Ub, WoutT, M, D, D}; pg8::StaticOrder S; S.init(M, D, G, bid);
        EpiRes E{argp(0), out, argp(9)}; pg8::gemm_phase<EpiRes, pg8::StaticOrder, true, true>(lds, g, S, E); }
    SEAM(3);
    if (IN(4)) ln_phase(out, Xb, argp(15), argp(16), gw, NGW, lane);
    SEAM(4);
    if (IN(5)) { pg8::Gemm g{Xb, WupT, M, FF, D}; pg8::StaticOrder S; S.init(M, FF, G, bid);
        EpiBf<1> E{Hb, FF}; pg8::gemm_phase<EpiBf<1>, pg8::StaticOrder, true, true>(lds, g, S, E); }
    SEAM(5);
    if (IN(6)) { pg8::Gemm g{Hb, WdnT, M, D, FF}; pg8::StaticOrder S; S.init(M, D, G, bid);
        EpiRes E{out, out, nullptr}; pg8::gemm_phase<EpiRes, pg8::StaticOrder, true, true>(lds, g, S, E); }
    SEAM(6);
    if (IN(7)) ln_phase(out, Xb, argp(19), argp(20), gw, NGW, lane);
    SEAM(7);
    if (IN(8)) {
#pragma unroll 1
        for (int pass = 0; pass < 2; ++pass) {
            pg8::Gemm g{pass ? Xb : Pb, pass ? WgateT : WprojT, M, D, pass ? D : PLE}; pg8::StaticOrder S; S.init(M, D, G, bid);
            EpiGate E{out, PP, Xb2, pass}; pg8::gemm_phase<EpiGate, pg8::StaticOrder, true, true>(lds, g, S, E);
            __syncthreads();
        }
    }
    SEAM(8);
    if (IN(9)) { pg8::Gemm g{Xb2, WkvqT, M, NKVQ, D}; pg8::StaticOrder S; S.init(M, NKVQ, G, bid);
        EpiKVQ E{KVQ, rope}; pg8::gemm_phase<EpiKVQ, pg8::StaticOrder, true, true>(lds, g, S, E); }
    SEAM(9);
    if (IN(10)) attn_phase(lds, KVQ, AO, argp(13), G, bid);
    SEAM(10);
    if (IN(11)) { pg8::Gemm g{AO, WoT, M, D, D}; pg8::StaticOrder S; S.init(M, D, G, bid);
        EpiRes E{out, out, nullptr}; pg8::gemm_phase<EpiRes, pg8::StaticOrder, true, true>(lds, g, S, E); }
    SEAM(11);
    if (IN(12)) ln_phase(out, Xb, argp(15) + D, argp(16) + D, gw, NGW, lane);
    SEAM(12);
    if (IN(13)) { pg8::Gemm g{Xb, WupT + (size_t)D * FF, M, FF, D}; pg8::StaticOrder S; S.init(M, FF, G, bid);
        EpiBf<1> E{Hb, FF}; pg8::gemm_phase<EpiBf<1>, pg8::StaticOrder, true, true>(lds, g, S, E); }
    SEAM(13);
    if (IN(14)) { pg8::Gemm g{Hb, WdnT + (size_t)D * FF, M, D, FF}; pg8::StaticOrder S; S.init(M, D, G, bid);
        EpiRes E{out, out, nullptr}; pg8::gemm_phase<EpiRes, pg8::StaticOrder, true, true>(lds, g, S, E); }
    SEAM(14);
    if (IN(15)) ln_phase(out, Xb, argp(19) + D, argp(20) + D, gw, NGW, lane);
    SEAM(15);
    if (IN(16)) {
#pragma unroll 1
        for (int pass = 0; pass < 2; ++pass) {
            pg8::Gemm g{pass ? Xb : Pb + (size_t)M * PLE, pass ? WgateT + (size_t)D * D : WprojT + (size_t)PLE * D, M, D, pass ? D : PLE}; pg8::StaticOrder S; S.init(M, D, G, bid);
            EpiGate E{out, PP, nullptr, pass}; pg8::gemm_phase<EpiGate, pg8::StaticOrder, true, true>(lds, g, S, E);
            __syncthreads();
        }
    }
#undef IN
#undef SEAM
}

extern "C" void kernel_launch(void* const* d_in, const int* in_sizes, int n_in, void* d_out, int out_size, void* d_ws, size_t ws_size, hipStream_t stream) {
    static int grid = 0;
    if (grid == 0) {
        if (n_in != 23 || in_sizes[0] != M * D || out_size != M * D || ws_size < WS_END) { fprintf(stderr, "kernel_launch: unexpected shapes (n_in %d, in0 %d, out %d, ws %zu); nothing launched\n", n_in, n_in > 0 ? in_sizes[0] : -1, out_size, ws_size); grid = -1; return; }
        int dev = 0, cus = 0, per_cu = 0;
        if (hipGetDevice(&dev) != hipSuccess || hipDeviceGetAttribute(&cus, hipDeviceAttributeMultiprocessorCount, dev) != hipSuccess) { grid = -1; return; }
        if (hipFuncSetAttribute((const void*)yoco_fwd, hipFuncAttributeMaxDynamicSharedMemorySize, LDS_BYTES) != hipSuccess) { fprintf(stderr, "kernel_launch: hipFuncSetAttribute failed\n"); grid = -1; return; }
        if (hipOccupancyMaxActiveBlocksPerMultiprocessor(&per_cu, (const void*)yoco_fwd, NWAVES * 64, LDS_BYTES) != hipSuccess || per_cu < 1) { fprintf(stderr, "kernel_launch: occupancy query gave %d\n", per_cu); per_cu = 1; }
        (void)hipGetLastError();
        grid = cus * per_cu;
    }
    if (grid < 0) return;
    Args a{};
    for (int i = 0; i < 23; ++i) a.in[i] = (const float*)d_in[i];
    a.out = (float*)d_out; a.ws = (unsigned char*)d_ws;
#if MK_PER_PHASE
    for (int ph = 0; ph < NPH; ++ph) { a.ph_lo = ph; a.ph_hi = ph + 1; void* kargs[] = {&a};
        hipError_t e = hipLaunchCooperativeKernel((const void*)yoco_fwd, dim3(grid), dim3(NWAVES * 64), kargs, LDS_BYTES, stream);
        if (e != hipSuccess) { fprintf(stderr, "cooperative launch (phase %d) failed: %s (grid %d)\n", ph, hipGetErrorString(e), grid); break; } }
#else
    a.ph_lo = 0; a.ph_hi = NPH; void* kargs[] = {&a};
    hipError_t e = hipLaunchCooperativeKernel((const void*)yoco_fwd, dim3(grid), dim3(NWAVES * 64), kargs, LDS_BYTES, stream);
    if (e != hipSuccess) fprintf(stderr, "cooperative launch failed: %s (grid %d)\n", hipGetErrorString(e), grid);
#endif
}
```
